# Optimizing an MI355X kernel written in HIP

```python
import math
import jax, jax.numpy as jnp
from jax import lax
import numpy as np

D_MODEL = 1024
BATCH = 8
SEQ = 2048
DEPTH = 4
DEC_BATCH = 128
DEC_SEQ = 1
PAST_LEN = 8192
PAGE_SIZE = 128

HEAD_DIM = 64
N_HEADS = 8
N_KV_HEADS = 2
GROUP = N_HEADS // N_KV_HEADS
Q_WIDTH = N_HEADS * HEAD_DIM
KV_WIDTH = N_KV_HEADS * HEAD_DIM
WINDOW = 128
N_BUCKETS = 32
MAX_DISTANCE = 128
LRU_WIDTH = D_MODEL
LRU_HEADS = 8
LRU_BLOCK = LRU_WIDTH // LRU_HEADS
LRU_C = 8.0
CONV_WIDTH = 4
D_FF = -(-8 * D_MODEL // (3 * 256)) * 256
PLE_DIM = 256
IN_WIDTH = Q_WIDTH + 2 * KV_WIDTH + 2 * LRU_WIDTH + 2 * D_MODEL
EPS = 1e-6
NEG_INF = -1e30

kernel_name = 'hybrid_swa_rglru_step'


def rms_norm(x, g):
    xf = x.astype(jnp.float32)
    y = xf * lax.rsqrt(jnp.mean(xf * xf, axis=-1, keepdims=True) + EPS)
    return (y * g.astype(jnp.float32)).astype(x.dtype)


def t5_bucket(dist):
    n = jnp.maximum(dist, 0)
    max_exact = N_BUCKETS // 2
    nf = jnp.maximum(n, 1).astype(jnp.float32)
    large = max_exact + (jnp.log(nf / max_exact) / math.log(MAX_DISTANCE / max_exact)
                         * (N_BUCKETS - max_exact)).astype(jnp.int32)
    large = jnp.minimum(large, N_BUCKETS - 1)
    return jnp.where(n < max_exact, n, large)


def window_attention(q, k, v, dist, valid, t5_table, sinks):
    s = jnp.einsum('bnqkgd,bnskd->bnkgqs', q, k,
                   preferred_element_type=jnp.float32) * (HEAD_DIM ** -0.5)
    bias = jnp.take(t5_table, t5_bucket(dist), axis=0)
    bias = jnp.transpose(bias, (2, 0, 1)).reshape(N_KV_HEADS, GROUP, *dist.shape)
    s = jnp.where(valid, s + bias.astype(jnp.float32), NEG_INF)
    sink = jnp.broadcast_to(sinks.astype(jnp.float32).reshape(N_KV_HEADS, GROUP, 1, 1),
                            s.shape[:-1] + (1,))
    pr = jax.nn.softmax(jnp.concatenate([s, sink], axis=-1), axis=-1)[..., :-1]
    return jnp.einsum('bnkgqs,bnskd->bnqkgd', pr.astype(v.dtype), v)


def causal_conv(xb, buf, w, b):
    L = xb.shape[1]
    xp = jnp.concatenate([buf.astype(xb.dtype), xb], axis=1)
    y = b + sum(w[j] * xp[:, j:j + L] for j in range(CONV_WIDTH))
    return y, xp[:, L:]


def rg_lru(xb, h0, w_a, b_a, w_x, b_x, lam):
    B, L, _ = xb.shape
    f32 = jnp.float32
    xf = xb.astype(f32)
    xh = xf.reshape(B, L, LRU_HEADS, LRU_BLOCK)
    r = jax.nn.sigmoid(jnp.einsum('blhi,hij->blhj', xh, w_a.astype(f32)).reshape(B, L, LRU_WIDTH)
                       + b_a.astype(f32))
    ig = jax.nn.sigmoid(jnp.einsum('blhi,hij->blhj', xh, w_x.astype(f32)).reshape(B, L, LRU_WIDTH)
                        + b_x.astype(f32))
    log_a = -LRU_C * r * jax.nn.softplus(-lam.astype(f32))
    a = jnp.exp(log_a)
    b = jnp.sqrt(-jnp.expm1(2.0 * log_a)) * (ig * xf)
    b = b.at[:, 0].add(a[:, 0] * h0.astype(f32))

    def combine(lhs, rhs):
        a1, b1 = lhs
        a2, b2 = rhs
        return a1 * a2, a2 * b1 + b2

    _, h = lax.associative_scan(combine, (a, b), axis=1)
    return h.astype(xb.dtype), h[:, -1].astype(h0.dtype)


def decoder_layer(x, p, k_buf, v_buf, h0, conv_buf, is_prompt, t5_table, ln1, w_in, q_gain,
                  k_gain, sinks, w_o_attn, conv_w, conv_b, w_a, b_a, w_x, b_x, lam, w_o_lru,
                  w_out, ln2, w_gate, w_up, w_down, ln3, w_ple, w_ple_gate):
    B, L, _ = x.shape
    h = rms_norm(x, ln1)
    proj = h @ w_in
    splits = np.cumsum([Q_WIDTH, KV_WIDTH, KV_WIDTH, LRU_WIDTH, LRU_WIDTH, D_MODEL]).tolist()
    q, k, v, xr, xg, g_att, g_lru = jnp.split(proj, splits, axis=-1)

    q = rms_norm(q.reshape(B, L, N_KV_HEADS, GROUP, HEAD_DIM), q_gain)
    k = rms_norm(k.reshape(B, L, N_KV_HEADS, HEAD_DIM), k_gain)
    v = v.reshape(B, L, N_KV_HEADS, HEAD_DIM)
    if is_prompt:
        nb = L // WINDOW
        qb = q.reshape(B, nb, WINDOW, N_KV_HEADS, GROUP, HEAD_DIM)

        def band(t):
            tb = t.reshape(B, nb, WINDOW, N_KV_HEADS, HEAD_DIM)
            prev = jnp.concatenate([jnp.zeros_like(tb[:, :1]), tb[:, :-1]], axis=1)
            return jnp.concatenate([prev, tb], axis=2)

        kb, vb = band(k), band(v)
        qloc = WINDOW + jnp.arange(WINDOW)
        kloc = jnp.arange(2 * WINDOW)
        dist = qloc[:, None] - kloc[None, :]
        kabs = jnp.arange(nb)[:, None, None] * WINDOW - WINDOW + kloc[None, None, :]
        valid = (((dist >= 0) & (dist < WINDOW))[None] & (kabs >= 0))[:, None, None]
        o = window_attention(qb, kb, vb, dist, valid, t5_table, sinks)
        new_k, new_v = k[:, L - WINDOW:], v[:, L - WINDOW:]
    else:
        W = k_buf.shape[1]
        kc = jnp.concatenate([k_buf.astype(k.dtype), k], axis=1)
        vc = jnp.concatenate([v_buf.astype(v.dtype), v], axis=1)
        qpos = PAST_LEN + jnp.arange(L)
        kpos = jnp.concatenate([PAST_LEN - W + jnp.arange(W), qpos])
        dist = qpos[:, None] - kpos[None, :]
        valid = ((dist >= 0) & (dist < WINDOW))[None, None, None]
        o = window_attention(q[:, None], kc[:, None], vc[:, None], dist, valid, t5_table, sinks)
        new_k, new_v = kc[:, L:], vc[:, L:]
    o_att = o.reshape(B, L, Q_WIDTH) @ w_o_attn

    xc, new_conv = causal_conv(xr, conv_buf, conv_w, conv_b)
    hseq, new_h = rg_lru(xc, h0, w_a, b_a, w_x, b_x, lam)
    o_lru = (hseq * jax.nn.gelu(xg)) @ w_o_lru

    x = x + (jax.nn.sigmoid(g_att) * o_att + jax.nn.sigmoid(g_lru) * o_lru) @ w_out

    h2 = rms_norm(x, ln2)
    x = x + (jax.nn.silu(h2 @ w_gate) * (h2 @ w_up)) @ w_down

    x = x + jax.nn.sigmoid(rms_norm(x, ln3) @ w_ple_gate) * (p @ w_ple)
    return x, new_k, new_v, new_h, new_conv


def setup_inputs(seed: int = 0) -> dict:
    key = jax.random.key(seed)
    ks = jax.random.split(key, 32)
    f32 = jnp.float32
    win_buf = min(WINDOW, PAST_LEN)

    def nrm(k, shape, scale=1.0):
        return jax.random.normal(k, shape, f32) * scale

    u = jax.random.uniform(ks[20], (DEPTH, LRU_WIDTH), f32, 0.9, 0.999)
    sa = u ** (1.0 / LRU_C)
    lam = jnp.log(sa) - jnp.log1p(-sa)
    return {
        'x_prompt': nrm(ks[0], (BATCH, SEQ, D_MODEL)),
        'x_sample': nrm(ks[1], (DEC_BATCH, DEC_SEQ, D_MODEL)),
        'cache_k_win': nrm(ks[2], (DEPTH, DEC_BATCH, win_buf, N_KV_HEADS, HEAD_DIM)),
        'cache_v_win': nrm(ks[3], (DEPTH, DEC_BATCH, win_buf, N_KV_HEADS, HEAD_DIM)),
        'state_lru_h': nrm(ks[4], (DEPTH, DEC_BATCH, LRU_WIDTH), 0.5),
        'state_conv': nrm(ks[5], (DEPTH, DEC_BATCH, CONV_WIDTH - 1, LRU_WIDTH)),
        'p_prompt': nrm(ks[6], (DEPTH, BATCH, SEQ, PLE_DIM)),
        'p_sample': nrm(ks[7], (DEPTH, DEC_BATCH, DEC_SEQ, PLE_DIM)),
        't5_table': nrm(ks[8], (N_BUCKETS, N_HEADS), 0.5),
        'ln1': 1.0 + nrm(ks[9], (DEPTH, D_MODEL), 0.1),
        'w_in': nrm(ks[10], (DEPTH, D_MODEL, IN_WIDTH), D_MODEL ** -0.5),
        'q_gain': 1.0 + nrm(ks[11], (DEPTH, HEAD_DIM), 0.1),
        'k_gain': 1.0 + nrm(ks[12], (DEPTH, HEAD_DIM), 0.1),
        'sinks': nrm(ks[13], (DEPTH, N_HEADS), 1.0),
        'w_o_attn': nrm(ks[14], (DEPTH, Q_WIDTH, D_MODEL), Q_WIDTH ** -0.5),
        'conv_w': nrm(ks[15], (DEPTH, CONV_WIDTH, LRU_WIDTH), CONV_WIDTH ** -0.5),
        'conv_b': nrm(ks[16], (DEPTH, LRU_WIDTH), 0.01),
        'w_a': nrm(ks[17], (DEPTH, LRU_HEADS, LRU_BLOCK, LRU_BLOCK), LRU_BLOCK ** -0.5),
        'b_a': nrm(ks[18], (DEPTH, LRU_WIDTH), 0.01),
        'w_x': nrm(ks[19], (DEPTH, LRU_HEADS, LRU_BLOCK, LRU_BLOCK), LRU_BLOCK ** -0.5),
        'b_x': nrm(ks[21], (DEPTH, LRU_WIDTH), 0.01),
        'lam': lam,
        'w_o_lru': nrm(ks[22], (DEPTH, LRU_WIDTH, D_MODEL), LRU_WIDTH ** -0.5),
        'w_out': nrm(ks[23], (DEPTH, D_MODEL, D_MODEL), D_MODEL ** -0.5),
        'ln2': 1.0 + nrm(ks[24], (DEPTH, D_MODEL), 0.1),
        'w_gate': nrm(ks[25], (DEPTH, D_MODEL, D_FF), D_MODEL ** -0.5),
        'w_up': nrm(ks[26], (DEPTH, D_MODEL, D_FF), D_MODEL ** -0.5),
        'w_down': nrm(ks[27], (DEPTH, D_FF, D_MODEL), D_FF ** -0.5),
        'ln3': 1.0 + nrm(ks[28], (DEPTH, D_MODEL), 0.1),
        'w_ple': nrm(ks[29], (DEPTH, PLE_DIM, D_MODEL), PLE_DIM ** -0.5),
        'w_ple_gate': nrm(ks[30], (DEPTH, D_MODEL, D_MODEL), D_MODEL ** -0.5),
    }


def reference(x_prompt, x_sample, cache_k_win, cache_v_win, state_lru_h, state_conv,
              p_prompt, p_sample, t5_table, ln1, w_in, q_gain, k_gain, sinks, w_o_attn,
              conv_w, conv_b, w_a, b_a, w_x, b_x, lam, w_o_lru, w_out, ln2, w_gate, w_up,
              w_down, ln3, w_ple, w_ple_gate):
    yp, ys = x_prompt, x_sample
    bp = x_prompt.shape[0]
    h0_p = jnp.zeros((bp, LRU_WIDTH), x_prompt.dtype)
    conv0_p = jnp.zeros((bp, CONV_WIDTH - 1, LRU_WIDTH), x_prompt.dtype)
    kp_l, vp_l, hp_l, cp_l = [], [], [], []
    ks_l, vs_l, hs_l, cs_l = [], [], [], []
    for i in range(DEPTH):
        lw = (t5_table, ln1[i], w_in[i], q_gain[i], k_gain[i], sinks[i], w_o_attn[i],
              conv_w[i], conv_b[i], w_a[i], b_a[i], w_x[i], b_x[i], lam[i], w_o_lru[i],
              w_out[i], ln2[i], w_gate[i], w_up[i], w_down[i], ln3[i], w_ple[i], w_ple_gate[i])
        yp, kp, vp, hp, cp = decoder_layer(yp, p_prompt[i], None, None, h0_p, conv0_p,
                                           True, *lw)
        ys, kss, vss, hss, css = decoder_layer(ys, p_sample[i], cache_k_win[i], cache_v_win[i],
                                               state_lru_h[i], state_conv[i], False, *lw)
        kp_l.append(kp); vp_l.append(vp); hp_l.append(hp); cp_l.append(cp)
        ks_l.append(kss); vs_l.append(vss); hs_l.append(hss); cs_l.append(css)
    new_k_win_prompt = jnp.stack(kp_l)
    new_v_win_prompt = jnp.stack(vp_l)
    new_lru_h_prompt = jnp.stack(hp_l)
    new_conv_prompt = jnp.stack(cp_l)
    new_k_win_sample = jnp.stack(ks_l)
    new_v_win_sample = jnp.stack(vs_l)
    new_lru_h_sample = jnp.stack(hs_l)
    new_conv_sample = jnp.stack(cs_l)
    return (yp, ys, new_k_win_prompt, new_v_win_prompt, new_lru_h_prompt, new_conv_prompt,
            new_k_win_sample, new_v_win_sample, new_lru_h_sample, new_conv_sample)
```

```cpp
#include <hip/hip_runtime.h>
#include <cstdio>
#include <cstdint>

constexpr int D = 1024, NB = 8, SEQ = 2048, DEPTH = 4, MS = 128;
constexpr int MP = NB * SEQ;
constexpr int MT = MP + MS;
constexpr int MPAD = 65 * 256;
constexpr int INW = 4864, DFF = 2816, NGU = 2 * DFF, KO = 1536, PLE = 256, QW = 512, KVW = 128;
constexpr float EPS = 1e-6f;
constexpr float LOG2E = 1.4426950408889634f;
constexpr float QSCALE = 0.125f * LOG2E;

namespace pg8 {
#define PG8_LAS __attribute__((address_space(3)))
typedef unsigned short bf16_t;
typedef short bf16x8 __attribute__((ext_vector_type(8)));
typedef float f32x4 __attribute__((ext_vector_type(4)));
typedef unsigned u32x4 __attribute__((ext_vector_type(4)));
constexpr int BM = 256, BK = 64, HALF = 128, HTB = HALF * BK * 2, STAGE_BYTES = 8 * HTB, NXCD = 8, WGM = 8;

__host__ __device__ __forceinline__ int lds_byte(int r, int c) { const int st = (r >> 4) * 2 + (c >> 5), rr = r & 15, cc = c & 31, ob = rr * 64 + cc * 2; return st * 1024 + (ob ^ (((ob >> 9) & 1) << 5)); }
__host__ __device__ __forceinline__ void stage_rc(int b, int& R, int& C) { const int st = b / 1024, sb = b % 1024, swz = sb ^ (((sb >> 9) & 1) << 5); R = (st >> 1) * 16 + swz / 64; C = (st & 1) * 32 + (swz % 64) / 2; }
__host__ __device__ __forceinline__ int perm32(int rho) { const int n = rho >> 4, i = rho & 15; return 8 * (i >> 2) + 4 * n + (i & 3); }

struct Unit { int pm, pn; };
struct Gemm { const bf16_t* A; const bf16_t* Bt; int M, N, K; };

struct StaticOrder {
    int nM, nN, nwg, G, c;
    __host__ __device__ void init(int M, int N, int G_, int c_) { nM = M / BM; nN = N / BM; nwg = nM * nN; G = G_; c = c_; }
    __host__ __device__ bool next(int i, Unit& u) const {
        const long L = (long)i * G + c; if (c < 0 || L >= nwg) return false;
        int wgid = (int)L; { const int q = nwg / NXCD, r = nwg % NXCD, xcd = wgid % NXCD, off = wgid / NXCD; wgid = (xcd < r ? xcd * (q + 1) : r * (q + 1) + (xcd - r) * q) + off; }
        const int nig = WGM * nN, gid = wgid / nig, fm = gid * WGM, gsz = (nM - fm) < WGM ? (nM - fm) : WGM;
        u.pm = fm + ((wgid % nig) % gsz); u.pn = (wgid % nig) / gsz; return true;
    }
    __device__ __forceinline__ void a_ready(const Unit&) const {}
    __device__ __forceinline__ void done(const Unit&) const {}
};

__device__ __forceinline__ unsigned cvt_pk_bf16(float lo, float hi) { unsigned r; asm volatile("v_cvt_pk_bf16_f32 %0, %1, %2" : "=v"(r) : "v"(lo), "v"(hi)); return r; }

template <class Epi, class Sched, bool ALIGN_EPI, bool SP2, int KSPLIT>
__device__ __forceinline__ void gemm_phase(PG8_LAS unsigned char* lds, const Gemm g, const Sched& S, const Epi& E) {
    int tid_ = threadIdx.x; asm volatile("" : "+v"(tid_));
    const int tid = tid_, wid = __builtin_amdgcn_readfirstlane(tid >> 6), lane = tid & 63, wr = wid >> 2, wc = wid & 3, fr = lane & 15, fq = lane >> 4;
    const int K = g.K, nt = K / BK;
    unsigned voffA[2], voffB[2];
#pragma unroll
    for (int i = 0; i < 2; ++i) { int R, C; stage_rc(tid * 16 + i * 8192, R, C); const int Rb = Epi::PERM ? ((R & ~31) + perm32(R & 31)) : R;
        voffA[i] = (unsigned)(R * K + C) * 2u; voffB[i] = (unsigned)(Rb * K + C) * 2u; }
    const size_t kstep = (size_t)(BK * 2);
    const size_t hstep = (size_t)HALF * K * 2;
    const size_t tstep = 2 * hstep;
    const unsigned ldsw = (unsigned)wid * 1024u;
    const int aoff = lds_byte(wr * 64 + fr, fq * 8), boff = lds_byte(wc * 32 + fr, fq * 8);
#define PG8_SA(b, h) (((b) * 2 + (h)) * HTB)
#define PG8_SB(b, h) ((4 + (b) * 2 + (h)) * HTB)
#define PG8_STAGE(bufoff, gbase, voff) do { _Pragma("unroll") for (int _i = 0; _i < 2; ++_i) \
        __builtin_amdgcn_global_load_lds((const unsigned*)((const char*)(gbase) + (voff)[_i]), (PG8_LAS unsigned*)(lds + (bufoff) + ldsw + _i * 8192), 16, 0, 0); } while (0)
#define PG8_LDA(dst, b, h) do { _Pragma("unroll") for (int m = 0; m < 4; ++m) _Pragma("unroll") for (int k = 0; k < 2; ++k) dst[m][k] = *(const PG8_LAS bf16x8*)(lds + PG8_SA(b, h) + aoff + m * 2048 + k * 1024); } while (0)
#define PG8_LDB(dst, b, h) do { _Pragma("unroll") for (int n = 0; n < 2; ++n) _Pragma("unroll") for (int k = 0; k < 2; ++k) dst[n][k] = *(const PG8_LAS bf16x8*)(lds + PG8_SB(b, h) + boff + n * 2048 + k * 1024); } while (0)
#define PG8_MMA(ai, bj, At, Bt) do { __builtin_amdgcn_s_setprio(1); _Pragma("unroll") for (int m = 0; m < 4; ++m) _Pragma("unroll") for (int n = 0; n < 2; ++n) _Pragma("unroll") for (int k = 0; k < 2; ++k) \
        acc[ai][bj][m][n] = __builtin_amdgcn_mfma_f32_16x16x32_bf16(Bt[n][k], At[m][k], acc[ai][bj][m][n], 0, 0, 0); __builtin_amdgcn_s_setprio(0); } while (0)
#define PG8_WAIT_V(n) asm volatile("s_waitcnt vmcnt(" #n ")" ::: "memory")
#define PG8_WAIT_L(n) asm volatile("s_waitcnt lgkmcnt(" #n ")" ::: "memory")
#define PG8_BAR __builtin_amdgcn_s_barrier()
#define PG8_SCHED __builtin_amdgcn_sched_barrier(0)
    Unit cur, nxt; int ui = 0;
    if (!S.next(0, cur)) return;
    f32x4 acc[2][2][4][2];
#pragma unroll
    for (int a = 0; a < 2; ++a)
#pragma unroll
        for (int b = 0; b < 2; ++b)
#pragma unroll
            for (int m = 0; m < 4; ++m)
#pragma unroll
                for (int n = 0; n < 2; ++n) acc[a][b][m][n] = (f32x4){0.f, 0.f, 0.f, 0.f};
    bf16x8 At[4][2], B0[2][2], B1[2][2];
    const char* cA = (const char*)g.A + (size_t)cur.pm * tstep; const char* cB = (const char*)g.Bt + (size_t)cur.pn * tstep;
    S.a_ready(cur);
    if constexpr (SP2) {
        PG8_STAGE(PG8_SB(0, 0), cB, voffB); PG8_STAGE(PG8_SB(0, 1), cB + hstep, voffB); PG8_STAGE(PG8_SA(0, 0), cA, voffA); PG8_STAGE(PG8_SA(0, 1), cA + hstep, voffA);
        if (wr == 1) PG8_BAR;
        PG8_WAIT_V(2); PG8_BAR;
        PG8_STAGE(PG8_SB(1, 0), cB + kstep, voffB); PG8_STAGE(PG8_SA(1, 0), cA + kstep, voffA); PG8_STAGE(PG8_SB(1, 1), cB + hstep + kstep, voffB);
        PG8_WAIT_V(6); PG8_BAR;
    } else {
        PG8_STAGE(PG8_SB(0, 0), cB, voffB); PG8_STAGE(PG8_SA(0, 0), cA, voffA); PG8_STAGE(PG8_SB(0, 1), cB + hstep, voffB); PG8_STAGE(PG8_SA(0, 1), cA + hstep, voffA);
        if (wr == 1) PG8_BAR;
        PG8_WAIT_V(4); PG8_BAR;
        PG8_STAGE(PG8_SB(1, 0), cB + kstep, voffB); PG8_STAGE(PG8_SA(1, 0), cA + kstep, voffA); PG8_STAGE(PG8_SB(1, 1), cB + hstep + kstep, voffB);
        PG8_WAIT_V(6); PG8_BAR;
    }
    for (;;) {
        const bool has_next = S.next(ui + 1, nxt);
        const char* nA = has_next ? (const char*)g.A + (size_t)nxt.pm * tstep : cA; const char* nB = has_next ? (const char*)g.Bt + (size_t)nxt.pn * tstep : cB;
#pragma unroll 1
        for (int t = 0; t < nt; t += 2) {
            const bool last = (t == nt - 2);
            const char* a1 = cA + (size_t)(t + 1) * kstep;
            const char* a2 = last ? nA : cA + (size_t)(t + 2) * kstep; const char* b2 = last ? nB : cB + (size_t)(t + 2) * kstep;
            const char* a3 = a2 + kstep; const char* b3 = b2 + kstep;
            if (last && has_next) S.a_ready(nxt);
            if constexpr (KSPLIT > 0) { if (t == KSPLIT) E.mid(acc, cur, wr, wc, fr, fq); }
            if constexpr (SP2) {
            PG8_LDB(B0, 0, 0); PG8_LDB(B1, 0, 1); PG8_SCHED; PG8_LDA(At, 0, 0); PG8_STAGE(PG8_SA(1, 1), a1 + hstep, voffA);
            PG8_WAIT_V(8); PG8_WAIT_L(0); PG8_BAR; PG8_MMA(0, 0, At, B0); PG8_MMA(0, 1, At, B1); PG8_BAR; PG8_SCHED;
            PG8_LDA(At, 0, 1); PG8_STAGE(PG8_SB(0, 0), b2, voffB); PG8_STAGE(PG8_SB(0, 1), b2 + hstep, voffB); PG8_STAGE(PG8_SA(0, 0), a2, voffA);
            PG8_WAIT_V(8); PG8_WAIT_L(0); PG8_BAR; PG8_MMA(1, 0, At, B0); PG8_MMA(1, 1, At, B1); PG8_BAR; PG8_SCHED;
            PG8_LDB(B0, 1, 0); PG8_LDB(B1, 1, 1); PG8_SCHED; PG8_LDA(At, 1, 0); PG8_STAGE(PG8_SA(0, 1), a2 + hstep, voffA);
            PG8_WAIT_V(8); PG8_WAIT_L(0); PG8_BAR; PG8_MMA(0, 0, At, B0); PG8_MMA(0, 1, At, B1); PG8_BAR; PG8_SCHED;
            PG8_LDA(At, 1, 1); PG8_STAGE(PG8_SB(1, 0), b3, voffB); PG8_STAGE(PG8_SB(1, 1), b3 + hstep, voffB); PG8_STAGE(PG8_SA(1, 0), a3, voffA);
            PG8_WAIT_V(8); PG8_WAIT_L(0); PG8_BAR; PG8_MMA(1, 0, At, B0); PG8_MMA(1, 1, At, B1); PG8_BAR; PG8_SCHED;
            } else {
            PG8_LDB(B0, 0, 0); PG8_SCHED; PG8_LDA(At, 0, 0); PG8_STAGE(PG8_SA(1, 1), a1 + hstep, voffA);
            PG8_WAIT_L(8); PG8_BAR; PG8_WAIT_L(0); PG8_MMA(0, 0, At, B0); PG8_BAR; PG8_SCHED;
            PG8_LDB(B1, 0, 1); PG8_STAGE(PG8_SB(0, 0), b2, voffB);
            PG8_BAR; PG8_WAIT_L(0); PG8_MMA(0, 1, At, B1); PG8_BAR;
            PG8_LDA(At, 0, 1); PG8_STAGE(PG8_SA(0, 0), a2, voffA);
            PG8_BAR; PG8_WAIT_L(0); PG8_MMA(1, 0, At, B0); PG8_BAR; PG8_SCHED;
            PG8_STAGE(PG8_SB(0, 1), b2 + hstep, voffB);
            PG8_WAIT_V(6); PG8_BAR; PG8_MMA(1, 1, At, B1); PG8_BAR;
            PG8_LDB(B0, 1, 0); PG8_SCHED; PG8_LDA(At, 1, 0); PG8_STAGE(PG8_SA(0, 1), a2 + hstep, voffA);
            PG8_WAIT_L(8); PG8_BAR; PG8_WAIT_L(0); PG8_MMA(0, 0, At, B0); PG8_BAR; PG8_SCHED;
            PG8_LDB(B1, 1, 1); PG8_STAGE(PG8_SB(1, 0), b3, voffB);
            PG8_BAR; PG8_WAIT_L(0); PG8_MMA(0, 1, At, B1); PG8_BAR;
            PG8_LDA(At, 1, 1); PG8_STAGE(PG8_SA(1, 0), a3, voffA);
            PG8_BAR; PG8_WAIT_L(0); PG8_MMA(1, 0, At, B0); PG8_BAR; PG8_SCHED;
            PG8_STAGE(PG8_SB(1, 1), b3 + hstep, voffB);
            PG8_WAIT_V(6); PG8_BAR; PG8_MMA(1, 1, At, B1); PG8_BAR;
            }
        }
        if constexpr (ALIGN_EPI) { if (wr == 0) PG8_BAR; }
        E(acc, cur, wr, wc, fr, fq); S.done(cur);
        if (!has_next) break;
#pragma unroll
        for (int a = 0; a < 2; ++a)
#pragma unroll
            for (int b = 0; b < 2; ++b)
#pragma unroll
                for (int m = 0; m < 4; ++m)
#pragma unroll
                    for (int n = 0; n < 2; ++n) acc[a][b][m][n] = (f32x4){0.f, 0.f, 0.f, 0.f};
        cur = nxt; cA = nA; cB = nB; ++ui;
        if constexpr (ALIGN_EPI) { if (wr == 1) PG8_BAR; }
    }
    PG8_WAIT_V(0);
    if constexpr (!ALIGN_EPI) { if (wr == 0) PG8_BAR; }
    PG8_BAR;
#undef PG8_SA
#undef PG8_SB
#undef PG8_STAGE
#undef PG8_LDA
#undef PG8_LDB
#undef PG8_MMA
#undef PG8_WAIT_V
#undef PG8_WAIT_L
#undef PG8_BAR
#undef PG8_SCHED
}
}

#define GAS __attribute__((address_space(1)))
#define LAS __attribute__((address_space(3)))
typedef unsigned short bf16;
typedef unsigned v4u __attribute__((ext_vector_type(4)));
typedef unsigned v2u __attribute__((ext_vector_type(2)));
typedef float f32x4 __attribute__((ext_vector_type(4)));
typedef float f32x16 __attribute__((ext_vector_type(16)));
typedef short bf16x8 __attribute__((ext_vector_type(8)));
typedef short v4i16_t __attribute__((ext_vector_type(4)));
typedef GAS unsigned gu32;
typedef GAS unsigned long long gu64;
#define RLX_AGENT __ATOMIC_RELAXED, __HIP_MEMORY_SCOPE_AGENT
#define LDS_WAIT() asm volatile("s_waitcnt lgkmcnt(0)" ::: "memory")
#define VM_WAIT() asm volatile("s_waitcnt vmcnt(0)" ::: "memory")
using pg8::cvt_pk_bf16;
__device__ __forceinline__ float bf_lo(unsigned w) { return __uint_as_float(w << 16); }
__device__ __forceinline__ float bf_hi(unsigned w) { return __uint_as_float(w & 0xffff0000u); }
__device__ __forceinline__ float ex2(float x) { return __builtin_amdgcn_exp2f(x); }
__device__ __forceinline__ float rcpf(float x) { return __builtin_amdgcn_rcpf(x); }
__device__ __forceinline__ float sigmoidf_(float v) { return rcpf(1.0f + ex2(-LOG2E * v)); }
__device__ __forceinline__ float siluf_(float v) { return v * rcpf(1.0f + ex2(-LOG2E * v)); }
__device__ __forceinline__ float geluf_(float v) { const float u = v * (1.0f + 0.044715f * v * v); return v * rcpf(1.0f + ex2(-2.0f * 0.7978845608028654f * LOG2E * u)); }
__device__ __forceinline__ float wave_sum(float v) {
#pragma unroll
    for (int o = 1; o < 64; o <<= 1) v += __shfl_xor(v, o);
    return v;
}

#define XB_TMO      128
#define XB_XCNT(j)  (256  + 64 * (j))
#define XB_XSUB(j)  (1280 + 64 * (j))
#define XB_XGEN(j)  (2304 + 64 * (j))
#define XB_TOP      3328
#define XB_TOPGEN   3392
#define XCD_BAR_WORDS 3456
#define XB_SPIN_CAP (1u << 18)
__device__ __forceinline__ unsigned xb_ld(unsigned* p)              { return __hip_atomic_load(p, __ATOMIC_RELAXED, __HIP_MEMORY_SCOPE_AGENT); }
__device__ __forceinline__ unsigned xb_add(unsigned* p, unsigned v) { return __hip_atomic_fetch_add(p, v, __ATOMIC_RELAXED, __HIP_MEMORY_SCOPE_AGENT); }
__device__ __forceinline__ unsigned xb_xcc_id() { return (unsigned)__builtin_amdgcn_s_getreg((3 << 11) | 20) & 0xFu; }
#define XB_SPIN(cond, bar) do { unsigned _sp = 0; while (cond) { __builtin_amdgcn_s_sleep(1); \
    if ((++_sp & 255u) == 0u) { if (xb_ld(&(bar)[XB_TMO])) break; if (_sp > XB_SPIN_CAP) { atomicAdd(&(bar)[XB_TMO], 1u); break; } } } } while (0)
struct XcdBarrier { unsigned* bar; unsigned x; volatile LAS unsigned* st; };
__device__ __forceinline__ XcdBarrier xcd_barrier_post(unsigned* bar, volatile LAS unsigned* st) {
    XcdBarrier b; b.bar = bar; b.x = xb_xcc_id(); b.st = st;
    if (threadIdx.x == 0) (void)xb_add(&bar[XB_XCNT(b.x)], 1u);
    return b;
}
__device__ __forceinline__ void xcd_barrier_complete(unsigned* bar, unsigned x, unsigned& nloc, unsigned& nx) {
    const unsigned G = gridDim.x * gridDim.y * gridDim.z;
    unsigned sum, cnt, mine, sp = 0u;
    for (;;) {
        sum = 0u; cnt = 0u; mine = 0u;
#pragma unroll
        for (unsigned j = 0; j < 16; ++j) { const unsigned c = xb_ld(&bar[XB_XCNT(j)]); sum += c; cnt += (c > 0u) ? 1u : 0u; }
        if (sum == G) break;
        __builtin_amdgcn_s_sleep(1);
        if ((++sp & 255u) == 0u) { if (xb_ld(&bar[XB_TMO])) break; if (sp > XB_SPIN_CAP) { atomicAdd(&bar[XB_TMO], 1u); break; } }
    }
    mine = xb_ld(&bar[XB_XCNT(x & 15u)]);
    nloc = mine > 0u ? mine : 1u; nx = cnt > 0u ? cnt : 1u;
}
__device__ __forceinline__ void xcd_barrier(const XcdBarrier& b) {
    asm volatile("s_waitcnt vmcnt(0)" ::: "memory");
    __syncthreads();
    if (threadIdx.x == 0) {
        unsigned* bar = b.bar; unsigned bx = b.x;
        asm volatile("" : "+v"(bar), "+v"(bx));
        __builtin_amdgcn_s_waitcnt(0);
        unsigned nloc = b.st[0], nx = b.st[1];
        if (nloc == 0u) { xcd_barrier_complete(bar, bx, nloc, nx); b.st[0] = nloc; b.st[1] = nx; }
        const unsigned old = xb_add(&bar[XB_XSUB(bx)], 1u);
        const unsigned gen = old / nloc;
        if (old + 1u == (gen + 1u) * nloc) {
            __builtin_amdgcn_fence(__ATOMIC_RELEASE, "agent");
            asm volatile("s_waitcnt vmcnt(0)" ::: "memory");
            const unsigned og = xb_add(&bar[XB_TOP], 1u);
            const unsigned tg = og / nx;
            if (og + 1u == (tg + 1u) * nx) xb_add(&bar[XB_TOPGEN], 1u);
            else XB_SPIN(xb_ld(&bar[XB_TOPGEN]) == tg, bar);
            __builtin_amdgcn_fence(__ATOMIC_ACQUIRE, "agent");
            xb_add(&bar[XB_XGEN(bx)], 1u);
            asm volatile("s_waitcnt vmcnt(0)" ::: "memory");
        } else {
            XB_SPIN(xb_ld(&bar[XB_XGEN(bx)]) == gen, bar);
            __builtin_amdgcn_fence(__ATOMIC_ACQUIRE, "agent");
            asm volatile("s_waitcnt vmcnt(0)" ::: "memory");
        }
    }
    __syncthreads();
}

constexpr size_t MiB = 1u << 20;
constexpr size_t WS_CTL = 0, CTL_ZERO_BYTES = 1 * MiB;
constexpr size_t WS_BT = 1 * MiB;
constexpr size_t WS_SS0 = 2 * MiB, WS_SS1 = 4 * MiB;
constexpr size_t WS_WIN = 6 * MiB;
constexpr size_t SZ_WIN = (size_t)INW * D * 2;
constexpr size_t WS_WO = WS_WIN + 38 * MiB;
constexpr size_t SZ_WO = (size_t)D * KO * 2;
constexpr size_t WS_WOUT = WS_WO + 12 * MiB;
constexpr size_t SZ_SQ = (size_t)D * D * 2;
constexpr size_t WS_WGU = WS_WOUT + 8 * MiB;
constexpr size_t SZ_WGU = (size_t)NGU * D * 2;
constexpr size_t WS_WDN = WS_WGU + 44 * MiB;
constexpr size_t SZ_WDN = (size_t)D * DFF * 2;
constexpr size_t WS_WPG = WS_WDN + 22 * MiB;
constexpr size_t WS_WPL = WS_WPG + 8 * MiB;
constexpr size_t SZ_WPL = (size_t)D * PLE * 2;
constexpr size_t WS_WAX = WS_WPL + 2 * MiB;
constexpr size_t SZ_WAX = (size_t)2 * 8 * 128 * 128 * 2;
constexpr size_t WS_XB0 = WS_WAX + 2 * MiB;
constexpr size_t SZ_ROWD = (size_t)MPAD * D * 2;
constexpr size_t WS_XB1 = WS_XB0 + 33 * MiB;
constexpr size_t WS_OH = WS_XB1 + 33 * MiB;
constexpr size_t WS_Q = WS_OH + 49 * MiB;
constexpr size_t WS_K = WS_Q + 17 * MiB;
constexpr size_t WS_V = WS_K + 5 * MiB;
constexpr size_t WS_MG = WS_Q;
constexpr size_t WS_PP = WS_OH;
constexpr size_t WS_XR = WS_Q + 33 * MiB;
constexpr size_t WS_XG = WS_XR + 33 * MiB, WS_GA = WS_XG + 33 * MiB, WS_GL = WS_GA + 33 * MiB;
constexpr size_t WS_H = WS_XR;
constexpr size_t WS_PB = WS_GL + 33 * MiB;
constexpr size_t SZ_PB = (size_t)MPAD * PLE * 2;
constexpr size_t WS_GRAN = WS_PB + 33 * MiB;
constexpr size_t SZ_GRAN = (size_t)4 * 8 * 32 * 1024 * 8;
constexpr size_t WS_END = WS_GRAN + 8 * MiB;
static_assert(SZ_WIN * 4 <= 38 * MiB && SZ_WO * 4 <= 12 * MiB && SZ_WGU * 4 <= 44 * MiB && SZ_WDN * 4 <= 22 * MiB && SZ_ROWD <= 33 * MiB, "ws map");
static_assert((size_t)MPAD * KO * 2 <= 49 * MiB && (size_t)MPAD * QW * 2 <= 17 * MiB && (size_t)MPAD * KVW * 2 <= 5 * MiB && (size_t)MPAD * D * 4 <= 82 * MiB && (size_t)MPAD * DFF * 2 <= 99 * MiB && SZ_PB * 4 <= 33 * MiB, "ws map 2");
constexpr int CW_BAR = 4096;

constexpr size_t O_YS = (size_t)MP * D;
constexpr size_t O_KP = O_YS + (size_t)MS * D;
constexpr size_t O_VP = O_KP + (size_t)DEPTH * NB * 128 * 128;
constexpr size_t O_HP = O_VP + (size_t)DEPTH * NB * 128 * 128;
constexpr size_t O_CP = O_HP + (size_t)DEPTH * NB * D;
constexpr size_t O_KS = O_CP + (size_t)DEPTH * NB * 3 * D;
constexpr size_t O_VS = O_KS + (size_t)DEPTH * MS * 128 * 128;
constexpr size_t O_HS = O_VS + (size_t)DEPTH * MS * 128 * 128;
constexpr size_t O_CS = O_HS + (size_t)DEPTH * MS * D;
constexpr size_t O_END = O_CS + (size_t)DEPTH * MS * 3 * D;
static_assert(O_END == 36962304, "d_out size");

constexpr int RING_OFF = 0, RING_BYTES = 131072;
constexpr int LDSCTL_OFF = RING_BYTES, MISC_OFF = LDSCTL_OFF + 320;
constexpr int LDS_BYTES = 147456;

struct Args { const float* in[31]; float* out; unsigned char* ws; };
enum { I_XP = 0, I_XS, I_CK, I_CV, I_SH, I_SC, I_PP, I_PS, I_T5, I_LN1, I_WIN, I_QG, I_KG, I_SINK, I_WOA, I_CW, I_CB, I_WA, I_BA, I_WX, I_BX, I_LAM, I_WOL, I_WOUT, I_LN2, I_WG, I_WU, I_WD, I_LN3, I_WPLE, I_WPG };

__device__ __forceinline__ float row_rstd(const float* SS, int row) {
    const f32x4* p = (const f32x4*)(SS + (size_t)row * 16);
    const f32x4 a = p[0], b = p[1], c = p[2], d = p[3];
    const float s = ((a[0] + a[1]) + (a[2] + a[3])) + ((b[0] + b[1]) + (b[2] + b[3])) + ((c[0] + c[1]) + (c[2] + c[3])) + ((d[0] + d[1]) + (d[2] + d[3]));
    return __builtin_amdgcn_rsqf(s * (1.0f / D) + EPS);
}
__device__ __forceinline__ v4u pack8(const f32x4 a, const f32x4 b) { v4u w; w.x = cvt_pk_bf16(a[0], a[1]); w.y = cvt_pk_bf16(a[2], a[3]); w.z = cvt_pk_bf16(b[0], b[1]); w.w = cvt_pk_bf16(b[2], b[3]); return w; }

struct EpiIn {
    static constexpr bool PERM = true;
    const float* SS; unsigned char* ws; const float *qg, *kg; float* out; int layer;
    __device__ __forceinline__ void mid(pg8::f32x4 (&)[2][2][4][2], const pg8::Unit&, int, int, int, int) const {}
    __device__ __forceinline__ void operator()(const pg8::f32x4 (&acc)[2][2][4][2], const pg8::Unit& u, int wr, int wc, int fr_, int fq) const {
        int fr = fr_; asm volatile("" : "+v"(fr));
        const int pn = u.pn, pm = u.pm;
        const bool special = ((pm & 7) == 7) || (pm == 64);
        if (pn <= 2) {
            const bool is_q = pn < 2, is_k = (pn == 2 && wc < 2), is_v = (pn == 2 && wc >= 2);
            const float* gain = is_q ? qg : kg;
            f32x4 g[2][2];
#pragma unroll
            for (int bj = 0; bj < 2; ++bj)
#pragma unroll
                for (int n = 0; n < 2; ++n) g[bj][n] = *(const f32x4*)(gain + 32 * bj + 8 * fq + 4 * n);
            const float post = is_q ? QSCALE : 1.0f;
            const int head = is_q ? (4 * pn + wc) : (wc & 1);
            bf16* dstb = (bf16*)(ws + (is_q ? WS_Q : (is_k ? WS_K : WS_V))); const int ldd = is_q ? QW : KVW;
#pragma unroll
            for (int ai = 0; ai < 2; ++ai)
#pragma unroll
                for (int m = 0; m < 4; ++m) {
                    const int row = pm * 256 + ai * 128 + wr * 64 + m * 16 + fr;
                    const float rs = row_rstd(SS, row);
                    f32x4 v[2][2]; float ss = 0.f;
#pragma unroll
                    for (int bj = 0; bj < 2; ++bj)
#pragma unroll
                        for (int n = 0; n < 2; ++n) { v[bj][n] = acc[ai][bj][m][n] * rs; const f32x4 t = v[bj][n]; ss += (t[0] * t[0] + t[1] * t[1]) + (t[2] * t[2] + t[3] * t[3]); }
                    ss += __shfl_xor(ss, 16); ss += __shfl_xor(ss, 32);
                    const float sc = is_v ? 1.0f : __builtin_amdgcn_rsqf(ss * (1.0f / 64.0f) + EPS);
                    float* fo = nullptr;
                    if (!is_q && special) {
                        if (row >= MP) { if (row < MT) fo = out + (is_k ? O_KS : O_VS) + ((((size_t)layer * MS + (row - MP)) * 128 + 127) * 2 + head) * 64; }
                        else { const int t = row & (SEQ - 1), b = row >> 11; if (t >= SEQ - 128) fo = out + (is_k ? O_KP : O_VP) + ((((size_t)layer * NB + b) * 128 + (t - (SEQ - 128))) * 2 + head) * 64; }
                    }
#pragma unroll
                    for (int bj = 0; bj < 2; ++bj) {
                        f32x4 o0, o1;
                        if (is_v) { o0 = v[bj][0]; o1 = v[bj][1]; }
                        else { o0 = v[bj][0] * g[bj][0] * sc; o1 = v[bj][1] * g[bj][1] * sc; }
                        const int d0 = 32 * bj + 8 * fq;
                        if (fo) { *(f32x4*)(fo + d0) = o0; *(f32x4*)(fo + d0 + 4) = o1; }
                        o0 = o0 * post; o1 = o1 * post;
                        *(v4u*)(dstb + (size_t)row * ldd + head * 64 + d0) = pack8(o0, o1);
                    }
                }
        } else {
            const int grp = (pn - 3) >> 2;
            const int ct = (pn - 3) & 3;
            bf16* dstb = (bf16*)(ws + WS_XR + (size_t)grp * (33 * MiB));
#pragma unroll
            for (int ai = 0; ai < 2; ++ai)
#pragma unroll
                for (int m = 0; m < 4; ++m) {
                    const int row = pm * 256 + ai * 128 + wr * 64 + m * 16 + fr;
                    const float rs = row_rstd(SS, row);
                    float* fo = nullptr;
                    if (grp == 0 && special) {
                        if (row >= MP) { if (row < MT) fo = out + O_CS + (((size_t)layer * MS + (row - MP)) * 3 + 2) * D; }
                        else { const int t = row & (SEQ - 1), b = row >> 11; if (t >= SEQ - 3) fo = out + O_CP + (((size_t)layer * NB + b) * 3 + (t - (SEQ - 3))) * D; }
                    }
#pragma unroll
                    for (int bj = 0; bj < 2; ++bj) {
                        f32x4 o0 = acc[ai][bj][m][0] * rs, o1 = acc[ai][bj][m][1] * rs;
                        const int col = ct * 256 + bj * 128 + wc * 32 + 8 * fq;
                        if (grp == 0) { if (fo) { *(f32x4*)(fo + col) = o0; *(f32x4*)(fo + col + 4) = o1; } }
                        else if (grp == 1) {
#pragma unroll
                            for (int i = 0; i < 4; ++i) { o0[i] = geluf_(o0[i]); o1[i] = geluf_(o1[i]); }
                        } else {
#pragma unroll
                            for (int i = 0; i < 4; ++i) { o0[i] = sigmoidf_(o0[i]); o1[i] = sigmoidf_(o1[i]); }
                        }
                        *(v4u*)(dstb + (size_t)row * D + col) = pack8(o0, o1);
                    }
                }
        }
    }
};

struct EpiMerge {
    static constexpr bool PERM = true;
    const bf16 *GA, *GL; bf16* MG;
    __device__ __forceinline__ void mid(pg8::f32x4 (&acc)[2][2][4][2], const pg8::Unit& u, int wr, int wc, int fr_, int fq) const {
        int fr = fr_; asm volatile("" : "+v"(fr));
#pragma unroll
        for (int ai = 0; ai < 2; ++ai)
#pragma unroll
            for (int m = 0; m < 4; ++m) {
                const int row = u.pm * 256 + ai * 128 + wr * 64 + m * 16 + fr;
#pragma unroll
                for (int bj = 0; bj < 2; ++bj) {
                    const size_t off = (size_t)row * D + u.pn * 256 + bj * 128 + wc * 32 + 8 * fq;
                    const v4u a = *(const v4u*)(GA + off), l = *(const v4u*)(GL + off);
                    f32x4 r0, r1;
                    r0[0] = bf_lo(a.x) * rcpf(bf_lo(l.x)); r0[1] = bf_hi(a.x) * rcpf(bf_hi(l.x)); r0[2] = bf_lo(a.y) * rcpf(bf_lo(l.y)); r0[3] = bf_hi(a.y) * rcpf(bf_hi(l.y));
                    r1[0] = bf_lo(a.z) * rcpf(bf_lo(l.z)); r1[1] = bf_hi(a.z) * rcpf(bf_hi(l.z)); r1[2] = bf_lo(a.w) * rcpf(bf_lo(l.w)); r1[3] = bf_hi(a.w) * rcpf(bf_hi(l.w));
                    acc[ai][bj][m][0] = acc[ai][bj][m][0] * r0; acc[ai][bj][m][1] = acc[ai][bj][m][1] * r1;
                }
                asm volatile("" ::: "memory");
            }
    }
    __device__ __forceinline__ void operator()(const pg8::f32x4 (&acc)[2][2][4][2], const pg8::Unit& u, int wr, int wc, int fr_, int fq) const {
        int fr = fr_; asm volatile("" : "+v"(fr));
#pragma unroll
        for (int ai = 0; ai < 2; ++ai)
#pragma unroll
            for (int m = 0; m < 4; ++m) {
                const int row = u.pm * 256 + ai * 128 + wr * 64 + m * 16 + fr;
#pragma unroll
                for (int bj = 0; bj < 2; ++bj) {
                    const size_t off = (size_t)row * D + u.pn * 256 + bj * 128 + wc * 32 + 8 * fq;
                    const v4u l = *(const v4u*)(GL + off);
                    f32x4 s0, s1;
                    s0[0] = bf_lo(l.x); s0[1] = bf_hi(l.x); s0[2] = bf_lo(l.y); s0[3] = bf_hi(l.y); s1[0] = bf_lo(l.z); s1[1] = bf_hi(l.z); s1[2] = bf_lo(l.w); s1[3] = bf_hi(l.w);
                    *(v4u*)(MG + off) = pack8(acc[ai][bj][m][0] * s0, acc[ai][bj][m][1] * s1);
                }
                asm volatile("" ::: "memory");
            }
    }
};

struct EpiResid {
    static constexpr bool PERM = true;
    float* X; bf16* XB; float* SSo;
    __device__ __forceinline__ void mid(pg8::f32x4 (&)[2][2][4][2], const pg8::Unit&, int, int, int, int) const {}
    __device__ __forceinline__ void operator()(const pg8::f32x4 (&acc)[2][2][4][2], const pg8::Unit& u, int wr, int wc, int fr_, int fq) const {
        int fr = fr_; asm volatile("" : "+v"(fr));
#pragma unroll
        for (int ai = 0; ai < 2; ++ai)
#pragma unroll
            for (int m = 0; m < 4; ++m) {
                const int row = u.pm * 256 + ai * 128 + wr * 64 + m * 16 + fr;
                const bool real = row < MT;
                float ss = 0.f;
#pragma unroll
                for (int bj = 0; bj < 2; ++bj) {
                    const size_t off = (size_t)row * D + u.pn * 256 + bj * 128 + wc * 32 + 8 * fq;
                    f32x4 x0 = (f32x4){0.f, 0.f, 0.f, 0.f}, x1 = x0;
                    if (real) { x0 = *(const f32x4*)(X + off); x1 = *(const f32x4*)(X + off + 4); }
                    x0 = x0 + acc[ai][bj][m][0]; x1 = x1 + acc[ai][bj][m][1];
                    if (real) { *(f32x4*)(X + off) = x0; *(f32x4*)(X + off + 4) = x1; }
                    *(v4u*)(XB + off) = pack8(x0, x1);
                    ss += (x0[0] * x0[0] + x0[1] * x0[1]) + (x0[2] * x0[2] + x0[3] * x0[3]) + (x1[0] * x1[0] + x1[1] * x1[1]) + (x1[2] * x1[2] + x1[3] * x1[3]);
                }
                ss += __shfl_xor(ss, 16); ss += __shfl_xor(ss, 32);
                if (fq == 0) SSo[(size_t)row * 16 + u.pn * 4 + wc] = ss;
            }
    }
};

struct EpiGLU {
    static constexpr bool PERM = true;
    const float* SS; bf16* H;
    __device__ __forceinline__ void mid(pg8::f32x4 (&)[2][2][4][2], const pg8::Unit&, int, int, int, int) const {}
    __device__ __forceinline__ void operator()(const pg8::f32x4 (&acc)[2][2][4][2], const pg8::Unit& u, int wr, int wc, int fr_, int fq) const {
        int fr = fr_; asm volatile("" : "+v"(fr));
#pragma unroll
        for (int ai = 0; ai < 2; ++ai)
#pragma unroll
            for (int m = 0; m < 4; ++m) {
                const int row = u.pm * 256 + ai * 128 + wr * 64 + m * 16 + fr;
                const float rs = row_rstd(SS, row);
                f32x4 o[2];
#pragma unroll
                for (int n = 0; n < 2; ++n) {
                    const f32x4 gt = acc[ai][0][m][n] * rs, up = acc[ai][1][m][n] * rs;
#pragma unroll
                    for (int i = 0; i < 4; ++i) o[n][i] = siluf_(gt[i]) * up[i];
                }
                *(v4u*)(H + (size_t)row * DFF + u.pn * 128 + wc * 32 + 8 * fq) = pack8(o[0], o[1]);
            }
    }
};

struct EpiPle {
    static constexpr bool PERM = true;
    const float* SSi; const float* PP; float* X; bf16* XB; float* SSo;
    __device__ __forceinline__ void mid(pg8::f32x4 (&)[2][2][4][2], const pg8::Unit&, int, int, int, int) const {}
    __device__ __forceinline__ void operator()(const pg8::f32x4 (&acc)[2][2][4][2], const pg8::Unit& u, int wr, int wc, int fr_, int fq) const {
        int fr = fr_; asm volatile("" : "+v"(fr));
#pragma unroll
        for (int ai = 0; ai < 2; ++ai)
#pragma unroll
            for (int m = 0; m < 4; ++m) {
                const int row = u.pm * 256 + ai * 128 + wr * 64 + m * 16 + fr;
                const bool real = row < MT;
                const float rs = row_rstd(SSi, row);
                float ss = 0.f;
#pragma unroll
                for (int bj = 0; bj < 2; ++bj) {
                    const size_t off = (size_t)row * D + u.pn * 256 + bj * 128 + wc * 32 + 8 * fq;
                    f32x4 x0 = (f32x4){0.f, 0.f, 0.f, 0.f}, x1 = x0;
                    if (real) { x0 = *(const f32x4*)(X + off); x1 = *(const f32x4*)(X + off + 4); }
                    const f32x4 p0 = *(const f32x4*)(PP + off), p1 = *(const f32x4*)(PP + off + 4);
                    const f32x4 a0 = acc[ai][bj][m][0] * rs, a1 = acc[ai][bj][m][1] * rs;
#pragma unroll
                    for (int i = 0; i < 4; ++i) { x0[i] += sigmoidf_(a0[i]) * p0[i]; x1[i] += sigmoidf_(a1[i]) * p1[i]; }
                    if (real) { *(f32x4*)(X + off) = x0; *(f32x4*)(X + off + 4) = x1; }
                    *(v4u*)(XB + off) = pack8(x0, x1);
                    ss += (x0[0] * x0[0] + x0[1] * x0[1]) + (x0[2] * x0[2] + x0[3] * x0[3]) + (x1[0] * x1[0] + x1[1] * x1[1]) + (x1[2] * x1[2] + x1[3] * x1[3]);
                }
                ss += __shfl_xor(ss, 16); ss += __shfl_xor(ss, 32);
                if (fq == 0) SSo[(size_t)row * 16 + u.pn * 4 + wc] = ss;
            }
    }
};

struct EpiF32 {
    static constexpr bool PERM = true;
    float* C;
    __device__ __forceinline__ void mid(pg8::f32x4 (&)[2][2][4][2], const pg8::Unit&, int, int, int, int) const {}
    __device__ __forceinline__ void operator()(const pg8::f32x4 (&acc)[2][2][4][2], const pg8::Unit& u, int wr, int wc, int fr_, int fq) const {
        int fr = fr_; asm volatile("" : "+v"(fr));
#pragma unroll
        for (int ai = 0; ai < 2; ++ai)
#pragma unroll
            for (int m = 0; m < 4; ++m) {
                const int row = u.pm * 256 + ai * 128 + wr * 64 + m * 16 + fr;
#pragma unroll
                for (int bj = 0; bj < 2; ++bj) {
                    const size_t off = (size_t)row * D + u.pn * 256 + bj * 128 + wc * 32 + 8 * fq;
                    *(f32x4*)(C + off) = acc[ai][bj][m][0]; *(f32x4*)(C + off + 4) = acc[ai][bj][m][1];
                }
            }
    }
};

struct Frame {
    LAS unsigned char* lds;
    int tid, lane, wave, cu;
    const float* const* in; GAS float* out; GAS unsigned char* ws;
};
#define WSP(T, off) ((T*)(GAS T*)(F.ws + (off)))
#define INP(i) ((const float*)(const GAS float*)F.in[i])
#define OUTP ((float*)F.out)

__device__ __forceinline__ int rowmap(int mode, int n) {
    if (mode == 1) { if (n < 768) { const int tile = n >> 8, t = n & 255, wc = t >> 6, bj = (t >> 5) & 1, x = t & 31; return tile * 256 + 128 * bj + 32 * wc + x; } return n; }
    if (mode == 2) return 256 * (n >> 7) + (n & 127);
    if (mode == 3) return 256 * (n >> 7) + 128 + (n & 127);
    return n;
}
__device__ __forceinline__ void tr_item(const float* W, int ldw, const float* g, bf16* WT, int ldk, int koff, int mode, LAS float* scr, int kb, int nb, int lane) {
    const int k0 = 64 * kb, n0 = 32 * nb;
#pragma unroll 8
    for (int i = 0; i < 32; ++i) { const int kk = 2 * i + (lane >> 5); float v = W[(size_t)(k0 + kk) * ldw + n0 + (lane & 31)]; if (g) v *= g[k0 + kk]; scr[kk * 33 + (lane & 31)] = v; }
    LDS_WAIT(); asm volatile("" ::: "memory");
    const int c = lane & 7;
#pragma unroll
    for (int j = 0; j < 4; ++j) { const int n = (lane >> 3) + 8 * j; const LAS float* s = scr + (8 * c) * 33 + n;
        v4u o; o.x = cvt_pk_bf16(s[0 * 33], s[1 * 33]); o.y = cvt_pk_bf16(s[2 * 33], s[3 * 33]); o.z = cvt_pk_bf16(s[4 * 33], s[5 * 33]); o.w = cvt_pk_bf16(s[6 * 33], s[7 * 33]);
        *(v4u*)(WT + (size_t)rowmap(mode, n0 + n) * ldk + koff + k0 + 8 * c) = o; }
    LDS_WAIT(); asm volatile("" ::: "memory");
}
constexpr int IT_WIN = 16 * 152, IT_WOA = 8 * 32, IT_WOL = 16 * 32, IT_WOUT = 16 * 32, IT_WG = 16 * 88, IT_WU = 16 * 88, IT_WD = 44 * 32, IT_WPG = 16 * 32, IT_WPL = 4 * 32, IT_WA = 8 * 8, IT_WX = 8 * 8;
constexpr int IT_LAYER = IT_WIN + IT_WOA + IT_WOL + IT_WOUT + IT_WG + IT_WU + IT_WD + IT_WPG + IT_WPL + IT_WA + IT_WX;

__device__ __forceinline__ void p0_prologue(const Frame& F) {
    LAS float* scr = (LAS float*)(F.lds + RING_OFF + F.wave * 16384);
    const int gw = F.cu * 8 + F.wave, NGW = 256 * 8;
    for (int it = gw; it < DEPTH * IT_LAYER; it += NGW) {
        const int l = it / IT_LAYER; int r = it % IT_LAYER;
        if (r < IT_WIN) { tr_item(INP(I_WIN) + (size_t)l * D * INW, INW, INP(I_LN1) + l * D, WSP(bf16, WS_WIN + l * SZ_WIN), D, 0, 1, scr, r / 152, r % 152, F.lane); continue; } r -= IT_WIN;
        if (r < IT_WOA) { tr_item(INP(I_WOA) + (size_t)l * QW * D, D, nullptr, WSP(bf16, WS_WO + l * SZ_WO), KO, 0, 0, scr, r / 32, r % 32, F.lane); continue; } r -= IT_WOA;
        if (r < IT_WOL) { tr_item(INP(I_WOL) + (size_t)l * D * D, D, nullptr, WSP(bf16, WS_WO + l * SZ_WO), KO, QW, 0, scr, r / 32, r % 32, F.lane); continue; } r -= IT_WOL;
        if (r < IT_WOUT) { tr_item(INP(I_WOUT) + (size_t)l * D * D, D, nullptr, WSP(bf16, WS_WOUT + l * SZ_SQ), D, 0, 0, scr, r / 32, r % 32, F.lane); continue; } r -= IT_WOUT;
        if (r < IT_WG) { tr_item(INP(I_WG) + (size_t)l * D * DFF, DFF, INP(I_LN2) + l * D, WSP(bf16, WS_WGU + l * SZ_WGU), D, 0, 2, scr, r / 88, r % 88, F.lane); continue; } r -= IT_WG;
        if (r < IT_WU) { tr_item(INP(I_WU) + (size_t)l * D * DFF, DFF, INP(I_LN2) + l * D, WSP(bf16, WS_WGU + l * SZ_WGU), D, 0, 3, scr, r / 88, r % 88, F.lane); continue; } r -= IT_WU;
        if (r < IT_WD) { tr_item(INP(I_WD) + (size_t)l * DFF * D, D, nullptr, WSP(bf16, WS_WDN + l * SZ_WDN), DFF, 0, 0, scr, r / 32, r % 32, F.lane); continue; } r -= IT_WD;
        if (r < IT_WPG) { tr_item(INP(I_WPG) + (size_t)l * D * D, D, INP(I_LN3) + l * D, WSP(bf16, WS_WPG + l * SZ_SQ), D, 0, 0, scr, r / 32, r % 32, F.lane); continue; } r -= IT_WPG;
        if (r < IT_WPL) { tr_item(INP(I_WPLE) + (size_t)l * PLE * D, D, nullptr, WSP(bf16, WS_WPL + l * SZ_WPL), PLE, 0, 0, scr, r / 32, r % 32, F.lane); continue; } r -= IT_WPL;
        if (r < IT_WA) { const int h = r >> 3, q = r & 7; tr_item(INP(I_WA) + ((size_t)l * 8 + h) * 128 * 128, 128, nullptr, WSP(bf16, WS_WAX + l * SZ_WAX) + (size_t)h * 128 * 128, 128, 0, 0, scr, q >> 2, q & 3, F.lane); continue; } r -= IT_WA;
        { const int h = r >> 3, q = r & 7; tr_item(INP(I_WX) + ((size_t)l * 8 + h) * 128 * 128, 128, nullptr, WSP(bf16, WS_WAX + l * SZ_WAX) + (size_t)(8 + h) * 128 * 128, 128, 0, 0, scr, q >> 2, q & 3, F.lane); }
    }
    {
        bf16* XB = WSP(bf16, WS_XB0); float* SS = WSP(float, WS_SS0);
        for (int m = gw; m < MT; m += NGW) {
            const float* src = m < MP ? INP(I_XP) + (size_t)m * D : INP(I_XS) + (size_t)(m - MP) * D;
            const f32x4* xr = (const f32x4*)src + F.lane; f32x4 v[4]; float s = 0.f;
#pragma unroll
            for (int j = 0; j < 4; ++j) { v[j] = xr[64 * j]; s += (v[j][0] * v[j][0] + v[j][1] * v[j][1]) + (v[j][2] * v[j][2] + v[j][3] * v[j][3]); }
            s = wave_sum(s);
            f32x4* xo = (f32x4*)(OUTP + (size_t)m * D) + F.lane; v2u* bo = (v2u*)(XB + (size_t)m * D) + F.lane;
#pragma unroll
            for (int j = 0; j < 4; ++j) { xo[64 * j] = v[j]; v2u w; w.x = cvt_pk_bf16(v[j][0], v[j][1]); w.y = cvt_pk_bf16(v[j][2], v[j][3]); bo[64 * j] = w; }
            if (F.lane < 16) SS[(size_t)m * 16 + F.lane] = F.lane == 0 ? s : 0.f;
        }
    }
    for (int r = gw; r < DEPTH * MT; r += NGW) {
        const int l = r / MT, m = r % MT;
        const float* src = m < MP ? INP(I_PP) + ((size_t)l * MP + m) * PLE : INP(I_PS) + ((size_t)l * MS + (m - MP)) * PLE;
        const f32x4 v = ((const f32x4*)src)[F.lane]; v2u w; w.x = cvt_pk_bf16(v[0], v[1]); w.y = cvt_pk_bf16(v[2], v[3]);
        ((v2u*)(WSP(bf16, WS_PB) + ((size_t)l * MPAD + m) * PLE))[F.lane] = w;
    }
    { v4u* gz = WSP(v4u, WS_GRAN); const v4u z = {0u, 0u, 0u, 0u}; for (size_t i = (size_t)F.cu * 512 + F.tid; i < SZ_GRAN / 16; i += 256 * 512) gz[i] = z; }
    for (size_t i = (size_t)F.cu * 512 + F.tid; i < (size_t)DEPTH * MS * 2 * (D / 4); i += 256 * 512) {
        const size_t ln = i / (2 * (D / 4)), rem = i % (2 * (D / 4)), rr = rem / (D / 4), c4 = rem % (D / 4);
        ((f32x4*)(OUTP + O_CS + (ln * 3 + rr) * D))[c4] = ((const f32x4*)(INP(I_SC) + (ln * 3 + rr + 1) * D))[c4];
    }
    if (F.cu == 0) {
        for (int i = F.tid; i < 8 * 128; i += 512) {
            const int h = i >> 7, n = i & 127; int bkt;
            if (n < 16) bkt = n; else { const float lf = __logf((float)n / 16.0f) / 2.0794415416798357f * 16.0f; bkt = 16 + (int)lf; if (bkt > 31) bkt = 31; }
            WSP(float, WS_BT)[i] = INP(I_T5)[bkt * 8 + h] * LOG2E;
        }
    }
}

constexpr int AT_K = 0, AT_V = 36864, AT_B = 73728, AT_ROW = 144;
__device__ __forceinline__ int crow(int r, int hi) { return (r & 3) + 8 * (r >> 2) + 4 * hi; }
__device__ __forceinline__ void attn_unit(const Frame& F, int layer, int b, int j, int kvh) {
    int tid_ = threadIdx.x; asm volatile("" : "+v"(tid_));
    const int tid = tid_, lane = tid & 63, wid = F.wave, r32 = lane & 31, hi = lane >> 5;
    const bf16* Qb = WSP(bf16, WS_Q); const bf16* Kg = WSP(bf16, WS_K); const bf16* Vg = WSP(bf16, WS_V); bf16* OH = WSP(bf16, WS_OH);
    LAS unsigned char* lds = F.lds;
    const long rowbase = (long)b * SEQ + (long)(j - 1) * 128;
#pragma unroll
    for (int i = 0; i < 4; ++i) {
        const int idx = tid + 512 * i, row = idx >> 3, ch = idx & 7;
        const bool valid = (j > 0) || (row >= 128);
        v4u kv = {0u, 0u, 0u, 0u}, vv = {0u, 0u, 0u, 0u};
        if (valid) { kv = *(const v4u*)(Kg + (size_t)(rowbase + row) * KVW + kvh * 64 + ch * 8); vv = *(const v4u*)(Vg + (size_t)(rowbase + row) * KVW + kvh * 64 + ch * 8); }
        *(LAS v4u*)(lds + AT_K + row * AT_ROW + ch * 16) = kv; *(LAS v4u*)(lds + AT_V + row * AT_ROW + ch * 16) = vv;
    }
    ((LAS float*)(lds + AT_B))[tid] = WSP(float, WS_BT)[(kvh * 4 + (tid >> 7)) * 128 + (tid & 127)];
    __syncthreads();
    const int hl = wid >> 1, hq = kvh * 4 + hl;
    const float sink = INP(I_SINK)[layer * 8 + hq] * LOG2E;
    const LAS float* BT = (const LAS float*)(lds + AT_B) + hl * 128;
    for (int qt = 0; qt < 2; ++qt) {
        const int it = (wid & 1) * 2 + qt;
        const long qrow0 = (long)b * SEQ + (long)j * 128 + 32 * it;
        bf16x8 qf[4];
#pragma unroll
        for (int s = 0; s < 4; ++s) qf[s] = *(const bf16x8*)(Qb + (size_t)(qrow0 + r32) * QW + hq * 64 + 16 * s + 8 * hi);
        const int kt0 = 32 * it;
        f32x16 p[5];
#pragma unroll
        for (int st = 0; st < 5; ++st) {
            f32x16 a = {};
#pragma unroll
            for (int s = 0; s < 4; ++s) { const bf16x8 kf = *(const LAS bf16x8*)(lds + AT_K + (kt0 + 32 * st + r32) * AT_ROW + (16 * s + 8 * hi) * 2); a = __builtin_amdgcn_mfma_f32_32x32x16_bf16(kf, qf[s], a, 0, 0, 0); }
            p[st] = a;
        }
        const int dbase = 128 + r32 - 4 * hi, kmin = 128 - 32 * it - 4 * hi;
        const LAS float* btp = BT + (dbase - 155);
        float mx = sink;
#pragma unroll
        for (int st = 0; st < 5; ++st)
#pragma unroll
            for (int r = 0; r < 16; ++r) {
                const int c = 32 * st + (r & 3) + 8 * (r >> 2);
                const bool ok = ((unsigned)(dbase - c) < 128u) && ((j > 0) || (c >= kmin));
                const float bv = btp[155 - c];
                const float s = ok ? p[st][r] + bv : -1e30f;
                p[st][r] = s; mx = fmaxf(mx, s);
            }
        mx = fmaxf(mx, __shfl_xor(mx, 32));
        float sum = 0.f;
#pragma unroll
        for (int st = 0; st < 5; ++st)
#pragma unroll
            for (int r = 0; r < 16; ++r) { const float e = ex2(p[st][r] - mx); p[st][r] = e; sum += e; }
        sum += __shfl_xor(sum, 32);
        sum += ex2(sink - mx);
        const float inv = 1.0f / sum;
        f32x16 o[2]; o[0] = (f32x16){}; o[1] = (f32x16){};
#pragma unroll
        for (int st = 0; st < 5; ++st)
#pragma unroll
            for (int s2 = 0; s2 < 2; ++s2) {
                v4u pw; pw.x = cvt_pk_bf16(p[st][8 * s2 + 0], p[st][8 * s2 + 1]); pw.y = cvt_pk_bf16(p[st][8 * s2 + 2], p[st][8 * s2 + 3]);
                pw.z = cvt_pk_bf16(p[st][8 * s2 + 4], p[st][8 * s2 + 5]); pw.w = cvt_pk_bf16(p[st][8 * s2 + 6], p[st][8 * s2 + 7]);
                const bf16x8 pa = __builtin_bit_cast(bf16x8, pw);
                const int keybase = kt0 + 32 * st + 16 * s2;
#pragma unroll
                for (int d0 = 0; d0 < 2; ++d0) {
                    const LAS unsigned char* ap = lds + AT_V + (keybase + 4 * hi + ((lane & 15) >> 2)) * AT_ROW + (d0 * 32 + ((lane >> 4) & 1) * 16 + (lane & 3) * 4) * 2;
                    const v4i16_t lo = __builtin_amdgcn_ds_read_tr16_b64_v4i16((LAS v4i16_t*)ap);
                    const v4i16_t hh = __builtin_amdgcn_ds_read_tr16_b64_v4i16((LAS v4i16_t*)(ap + 8 * AT_ROW));
                    const bf16x8 vb = (bf16x8){lo[0], lo[1], lo[2], lo[3], hh[0], hh[1], hh[2], hh[3]};
                    o[d0] = __builtin_amdgcn_mfma_f32_32x32x16_bf16(pa, vb, o[d0], 0, 0, 0);
                }
            }
#pragma unroll
        for (int r = 0; r < 16; ++r) {
            const int q = crow(r, hi); const float iv = __shfl(inv, q);
#pragma unroll
            for (int d0 = 0; d0 < 2; ++d0) OH[(size_t)(qrow0 + q) * KO + hq * 64 + d0 * 32 + r32] = (bf16)(cvt_pk_bf16(o[d0][r] * iv, 0.f) & 0xffffu);
        }
    }
    __syncthreads();
}

__device__ __forceinline__ void attn_sample_task(const Frame& F, int layer, int n, int kvh) {
    int lane_ = threadIdx.x & 63; asm volatile("" : "+v"(lane_));
    const int lane = lane_, wid = F.wave;
    LAS float* ql = (LAS float*)(F.lds + wid * 4096); LAS float* pl = ql + 256;
    const bf16* Qb = WSP(bf16, WS_Q); bf16* OH = WSP(bf16, WS_OH);
    const int row = MP + n;
#pragma unroll
    for (int g = 0; g < 4; ++g) ql[g * 64 + lane] = bf_lo((unsigned)Qb[(size_t)row * QW + (kvh * 4 + g) * 64 + lane]);
    LDS_WAIT(); asm volatile("" ::: "memory");
    const float* ck = INP(I_CK) + (((size_t)layer * MS + n) * 128) * 128 + kvh * 64;
    const float* cv = INP(I_CV) + (((size_t)layer * MS + n) * 128) * 128 + kvh * 64;
    float* ok = OUTP + O_KS + (((size_t)layer * MS + n) * 128) * 128 + kvh * 64;
    float* ov = OUTP + O_VS + (((size_t)layer * MS + n) * 128) * 128 + kvh * 64;
    const float* BT = WSP(float, WS_BT);
    float sc[2][4];
#pragma unroll
    for (int s = 0; s < 2; ++s) {
        const int idx = lane + 1 + 64 * s;
        const float* kp = idx < 128 ? ck + (size_t)idx * 128 : ok + (size_t)127 * 128;
        float a0 = 0.f, a1 = 0.f, a2 = 0.f, a3 = 0.f;
#pragma unroll 2
        for (int c = 0; c < 16; ++c) {
            const f32x4 kv = *(const f32x4*)(kp + 4 * c);
            const f32x4 q0 = *(const LAS f32x4*)(ql + 4 * c), q1 = *(const LAS f32x4*)(ql + 64 + 4 * c), q2 = *(const LAS f32x4*)(ql + 128 + 4 * c), q3 = *(const LAS f32x4*)(ql + 192 + 4 * c);
            a0 += (kv[0] * q0[0] + kv[1] * q0[1]) + (kv[2] * q0[2] + kv[3] * q0[3]); a1 += (kv[0] * q1[0] + kv[1] * q1[1]) + (kv[2] * q1[2] + kv[3] * q1[3]);
            a2 += (kv[0] * q2[0] + kv[1] * q2[1]) + (kv[2] * q2[2] + kv[3] * q2[3]); a3 += (kv[0] * q3[0] + kv[1] * q3[1]) + (kv[2] * q3[2] + kv[3] * q3[3]);
        }
        const int dist = 128 - idx;
        sc[s][0] = a0 + BT[(kvh * 4 + 0) * 128 + dist]; sc[s][1] = a1 + BT[(kvh * 4 + 1) * 128 + dist]; sc[s][2] = a2 + BT[(kvh * 4 + 2) * 128 + dist]; sc[s][3] = a3 + BT[(kvh * 4 + 3) * 128 + dist];
    }
    float inv[4];
#pragma unroll
    for (int g = 0; g < 4; ++g) {
        const float sink = INP(I_SINK)[layer * 8 + kvh * 4 + g] * LOG2E;
        float mx = fmaxf(fmaxf(sc[0][g], sc[1][g]), sink);
#pragma unroll
        for (int o = 1; o < 64; o <<= 1) mx = fmaxf(mx, __shfl_xor(mx, o));
        const float e0 = ex2(sc[0][g] - mx), e1 = ex2(sc[1][g] - mx);
        float sm = wave_sum(e0 + e1) + ex2(sink - mx);
        inv[g] = 1.0f / sm;
        pl[(lane + 1) * 4 + g] = e0; pl[(lane + 65) * 4 + g] = e1;
    }
    LDS_WAIT(); asm volatile("" ::: "memory");
    float o0 = 0.f, o1 = 0.f, o2 = 0.f, o3 = 0.f;
#pragma unroll 4
    for (int idx = 1; idx < 128; ++idx) {
        const float v = cv[(size_t)idx * 128 + lane]; const f32x4 pp = *(const LAS f32x4*)(pl + idx * 4);
        o0 += pp[0] * v; o1 += pp[1] * v; o2 += pp[2] * v; o3 += pp[3] * v;
        ov[(size_t)(idx - 1) * 128 + lane] = v;
        ok[(size_t)(idx - 1) * 128 + lane] = ck[(size_t)idx * 128 + lane];
    }
    { const float v = ov[(size_t)127 * 128 + lane]; const f32x4 pp = *(const LAS f32x4*)(pl + 128 * 4); o0 += pp[0] * v; o1 += pp[1] * v; o2 += pp[2] * v; o3 += pp[3] * v; }
    bf16* op = OH + (size_t)row * KO + kvh * 256 + lane;
    op[0] = (bf16)(cvt_pk_bf16(o0 * inv[0], 0.f) & 0xffffu); op[64] = (bf16)(cvt_pk_bf16(o1 * inv[1], 0.f) & 0xffffu);
    op[128] = (bf16)(cvt_pk_bf16(o2 * inv[2], 0.f) & 0xffffu); op[192] = (bf16)(cvt_pk_bf16(o3 * inv[3], 0.f) & 0xffffu);
    LDS_WAIT(); asm volatile("" ::: "memory");
}

constexpr int LR_XCB = 0, LR_XCF = 17408, LR_ROWB = 272, LR_ROWF = 528;
__device__ __forceinline__ float neg_expm1(float y) {
    if (y > -0.1f) return -y * (1.0f + y * (0.5f + y * (0.16666667f + y * (0.041666668f + y * 0.0083333338f))));
    return 1.0f - ex2(y * LOG2E);
}
template <bool SAMPLE>
__device__ __forceinline__ void lru_unit(const Frame& F, int layer, int b, int h, int c) {
    int tid_ = threadIdx.x; asm volatile("" : "+v"(tid_));
    const int tid = tid_, lane = tid & 63, wid = F.wave;
    LAS unsigned char* lds = F.lds;
    const bf16* XR = WSP(bf16, WS_XR); const bf16* XG = WSP(bf16, WS_XG); bf16* OH = WSP(bf16, WS_OH);
    const int ch0 = 128 * h;
    {
        const int tt = tid >> 3, cg = tid & 7, cb = ch0 + 16 * cg;
        float xc[16];
        { const f32x4* bp = (const f32x4*)(INP(I_CB) + layer * D + cb);
#pragma unroll
          for (int q = 0; q < 4; ++q) { const f32x4 v = bp[q]; xc[4 * q] = v[0]; xc[4 * q + 1] = v[1]; xc[4 * q + 2] = v[2]; xc[4 * q + 3] = v[3]; } }
#pragma unroll
        for (int jt = 0; jt < 4; ++jt) {
            float xv[16]; bool have = true;
            if (SAMPLE) {
                const int n = 64 * c + tt;
                if (jt < 3) { const f32x4* sp = (const f32x4*)(INP(I_SC) + (((size_t)layer * MS + n) * 3 + jt) * D + cb);
#pragma unroll
                    for (int q = 0; q < 4; ++q) { const f32x4 v = sp[q]; xv[4 * q] = v[0]; xv[4 * q + 1] = v[1]; xv[4 * q + 2] = v[2]; xv[4 * q + 3] = v[3]; } }
                else { const v4u* xp = (const v4u*)(XR + (size_t)(MP + n) * D + cb);
#pragma unroll
                    for (int q = 0; q < 2; ++q) { const v4u w = xp[q]; xv[8 * q] = bf_lo(w.x); xv[8 * q + 1] = bf_hi(w.x); xv[8 * q + 2] = bf_lo(w.y); xv[8 * q + 3] = bf_hi(w.y); xv[8 * q + 4] = bf_lo(w.z); xv[8 * q + 5] = bf_hi(w.z); xv[8 * q + 6] = bf_lo(w.w); xv[8 * q + 7] = bf_hi(w.w); } }
            } else {
                const int t = 64 * c + tt - (3 - jt);
                have = t >= 0;
                if (have) { const v4u* xp = (const v4u*)(XR + (size_t)(b * SEQ + t) * D + cb);
#pragma unroll
                    for (int q = 0; q < 2; ++q) { const v4u w = xp[q]; xv[8 * q] = bf_lo(w.x); xv[8 * q + 1] = bf_hi(w.x); xv[8 * q + 2] = bf_lo(w.y); xv[8 * q + 3] = bf_hi(w.y); xv[8 * q + 4] = bf_lo(w.z); xv[8 * q + 5] = bf_hi(w.z); xv[8 * q + 6] = bf_lo(w.w); xv[8 * q + 7] = bf_hi(w.w); } }
                else {
#pragma unroll
                    for (int q = 0; q < 16; ++q) xv[q] = 0.f; }
            }
            const f32x4* wp = (const f32x4*)(INP(I_CW) + ((size_t)layer * 4 + jt) * D + cb);
#pragma unroll
            for (int q = 0; q < 4; ++q) { const f32x4 w = wp[q]; xc[4 * q] += w[0] * xv[4 * q]; xc[4 * q + 1] += w[1] * xv[4 * q + 1]; xc[4 * q + 2] += w[2] * xv[4 * q + 2]; xc[4 * q + 3] += w[3] * xv[4 * q + 3]; }
        }
        LAS float* xf = (LAS float*)(lds + LR_XCF + tt * LR_ROWF) + 16 * cg;
#pragma unroll
        for (int q = 0; q < 4; ++q) *(LAS f32x4*)(xf + 4 * q) = (f32x4){xc[4 * q], xc[4 * q + 1], xc[4 * q + 2], xc[4 * q + 3]};
        LAS v4u* xb = (LAS v4u*)(lds + LR_XCB + tt * LR_ROWB + 32 * cg);
#pragma unroll
        for (int q = 0; q < 2; ++q) { v4u w; w.x = cvt_pk_bf16(xc[8 * q], xc[8 * q + 1]); w.y = cvt_pk_bf16(xc[8 * q + 2], xc[8 * q + 3]); w.z = cvt_pk_bf16(xc[8 * q + 4], xc[8 * q + 5]); w.w = cvt_pk_bf16(xc[8 * q + 6], xc[8 * q + 7]); xb[q] = w; }
    }
    __syncthreads();
    const int nl = 16 * wid + (lane & 15), q4 = lane >> 4, ch = ch0 + nl;
    pg8::f32x4 accA[4], accX[4];
    {
        const bf16* wa = WSP(bf16, WS_WAX + layer * SZ_WAX) + ((size_t)h * 128 + nl) * 128 + 8 * q4;
        const bf16* wx = wa + (size_t)8 * 128 * 128;
        bf16x8 fa[4], fx[4];
#pragma unroll
        for (int ks = 0; ks < 4; ++ks) { fa[ks] = *(const bf16x8*)(wa + 32 * ks); fx[ks] = *(const bf16x8*)(wx + 32 * ks); }
#pragma unroll
        for (int t4 = 0; t4 < 4; ++t4) {
            accA[t4] = (pg8::f32x4){0.f, 0.f, 0.f, 0.f}; accX[t4] = (pg8::f32x4){0.f, 0.f, 0.f, 0.f};
#pragma unroll
            for (int ks = 0; ks < 4; ++ks) {
                const bf16x8 af = *(const LAS bf16x8*)(lds + LR_XCB + (16 * t4 + (lane & 15)) * LR_ROWB + (32 * ks + 8 * q4) * 2);
                accA[t4] = __builtin_amdgcn_mfma_f32_16x16x32_bf16(af, fa[ks], accA[t4], 0, 0, 0);
                accX[t4] = __builtin_amdgcn_mfma_f32_16x16x32_bf16(af, fx[ks], accX[t4], 0, 0, 0);
            }
        }
    }
    float av[4][4], bv[4][4];
    {
        const float ba = INP(I_BA)[layer * D + ch], bx = INP(I_BX)[layer * D + ch], lam = INP(I_LAM)[layer * D + ch];
        const float sp = (lam < -20.f) ? -lam : log1pf(__expf(-lam));
        const float c8 = -8.0f * sp;
#pragma unroll
        for (int t4 = 0; t4 < 4; ++t4)
#pragma unroll
            for (int i = 0; i < 4; ++i) {
                const int t = 16 * t4 + 4 * q4 + i;
                const float xcv = ((const LAS float*)(lds + LR_XCF + t * LR_ROWF))[nl];
                const float r = sigmoidf_(accA[t4][i] + ba), ig = sigmoidf_(accX[t4][i] + bx);
                const float la = c8 * r;
                av[t4][i] = ex2(la * LOG2E);
                bv[t4][i] = __builtin_sqrtf(neg_expm1(2.0f * la)) * (ig * xcv);
            }
    }
    float hv[4][4];
    if (SAMPLE) {
#pragma unroll
        for (int t4 = 0; t4 < 4; ++t4)
#pragma unroll
            for (int i = 0; i < 4; ++i) {
                const int n = 64 * c + 16 * t4 + 4 * q4 + i;
                const float h0 = INP(I_SH)[((size_t)layer * MS + n) * D + ch];
                const float hn = av[t4][i] * h0 + bv[t4][i];
                hv[t4][i] = hn;
                OUTP[O_HS + ((size_t)layer * MS + n) * D + ch] = hn;
            }
    } else {
        float sA[4], sB[4];
#pragma unroll
        for (int t4 = 0; t4 < 4; ++t4) { float A = 1.f, B = 0.f;
#pragma unroll
            for (int i = 0; i < 4; ++i) { B = av[t4][i] * B + bv[t4][i]; A = A * av[t4][i]; }
            sA[t4] = A; sB[t4] = B; }
        float inA[4], inB[4], cA = 1.f, cB = 0.f;
        const int l0 = lane & 15;
#pragma unroll
        for (int t4 = 0; t4 < 4; ++t4) {
            const float a0 = __shfl(sA[t4], l0), b0 = __shfl(sB[t4], l0), a1 = __shfl(sA[t4], l0 + 16), b1 = __shfl(sB[t4], l0 + 16);
            const float a2 = __shfl(sA[t4], l0 + 32), b2 = __shfl(sB[t4], l0 + 32), a3 = __shfl(sA[t4], l0 + 48), b3 = __shfl(sB[t4], l0 + 48);
            float pA = cA, pB = cB;
            if (q4 > 0) { pB = a0 * pB + b0; pA = a0 * pA; }
            if (q4 > 1) { pB = a1 * pB + b1; pA = a1 * pA; }
            if (q4 > 2) { pB = a2 * pB + b2; pA = a2 * pA; }
            inA[t4] = pA; inB[t4] = pB;
            cB = a0 * cB + b0; cA = a0 * cA; cB = a1 * cB + b1; cA = a1 * cA; cB = a2 * cB + b2; cA = a2 * cA; cB = a3 * cB + b3; cA = a3 * cA;
        }
        gu64* gran = (gu64*)WSP(unsigned long long, WS_GRAN) + (((size_t)layer * NB + b) * 32) * D;
        float hin = 0.f;
        if (c > 0) {
            gu64* gp = gran + (size_t)(c - 1) * D + ch; unsigned long long w; unsigned spins = 0;
            for (;;) { w = __hip_atomic_load(gp, RLX_AGENT); const bool okk = (unsigned)(w >> 32) == 1u; if (__all(okk)) break; __builtin_amdgcn_s_sleep(2); if (++spins > (1u << 20)) break; }
            hin = __uint_as_float((unsigned)w);
        }
        const float hout = cA * hin + cB;
        if (q4 == 0) {
            if (c < 31) __hip_atomic_store(gran + (size_t)c * D + ch, (1ull << 32) | (unsigned long long)__float_as_uint(hout), RLX_AGENT);
            else OUTP[O_HP + ((size_t)layer * NB + b) * D + ch] = hout;
        }
#pragma unroll
        for (int t4 = 0; t4 < 4; ++t4) { float hc = inA[t4] * hin + inB[t4];
#pragma unroll
            for (int i = 0; i < 4; ++i) { hc = av[t4][i] * hc + bv[t4][i]; hv[t4][i] = hc; } }
    }
#pragma unroll
    for (int t4 = 0; t4 < 4; ++t4)
#pragma unroll
        for (int i = 0; i < 4; ++i) ((LAS float*)(lds + LR_XCF + (16 * t4 + 4 * q4 + i) * LR_ROWF))[nl] = hv[t4][i];
    __syncthreads();
    {
        const int tt = tid >> 3, cg = tid & 7, cb = ch0 + 16 * cg;
        const size_t row = SAMPLE ? (size_t)(MP + 64 * c + tt) : (size_t)b * SEQ + 64 * c + tt;
        const LAS float* xf = (const LAS float*)(lds + LR_XCF + tt * LR_ROWF) + 16 * cg;
        const v4u* gp = (const v4u*)(XG + row * D + cb); v4u* op = (v4u*)(OH + row * KO + QW + cb);
#pragma unroll
        for (int q = 0; q < 2; ++q) {
            const v4u g = gp[q]; const f32x4 h0 = *(const LAS f32x4*)(xf + 8 * q), h1 = *(const LAS f32x4*)(xf + 8 * q + 4);
            v4u w; w.x = cvt_pk_bf16(h0[0] * bf_lo(g.x), h0[1] * bf_hi(g.x)); w.y = cvt_pk_bf16(h0[2] * bf_lo(g.y), h0[3] * bf_hi(g.y));
            w.z = cvt_pk_bf16(h1[0] * bf_lo(g.z), h1[1] * bf_hi(g.z)); w.w = cvt_pk_bf16(h1[2] * bf_lo(g.w), h1[3] * bf_hi(g.w));
            op[q] = w;
        }
    }
    __syncthreads();
}

#ifndef MK_PHASE_STOP
#define MK_PHASE_STOP 1000
#endif
#define GRID_BAR() xcd_barrier(bar)
#define LAUNDER() asm volatile("" : "+s"(F.ws), "+s"(F.out))
#if MK_PHASE_STOP < 1000
#define PHASE_END() do { GRID_BAR(); if (++phase_no >= MK_PHASE_STOP) return; } while (0)
#else
#define PHASE_END() GRID_BAR()
#endif
__device__ __forceinline__ void layer_fwd(Frame& F, const XcdBarrier& bar, const int layer, int& phase_no) {
    const int cu = F.cu;

        float* SSa = WSP(float, (layer & 1) ? WS_SS1 : WS_SS0);
        float* SSb = WSP(float, (layer & 1) ? WS_SS0 : WS_SS1);
        {
            LAUNDER();
            pg8::Gemm g{WSP(bf16, WS_XB0), WSP(bf16, WS_WIN + layer * SZ_WIN), MPAD, INW, D};
            pg8::StaticOrder S; S.init(MPAD, INW, 256, cu);
            EpiIn E{SSa, (unsigned char*)F.ws, INP(I_QG) + layer * 64, INP(I_KG) + layer * 64, OUTP, layer};
#ifndef NO_P1
            pg8::gemm_phase<EpiIn, pg8::StaticOrder, true, true, 0>(F.lds + RING_OFF, g, S, E);
#endif
        }
        PHASE_END();
        {
            LAUNDER();
            const int bh = cu & 63, sub = cu >> 6;
#ifndef NO_P2L
            for (int r = 0; r < 8; ++r) lru_unit<false>(F, layer, bh >> 3, bh & 7, 4 * r + sub);
#endif
#ifndef NO_P2A
            attn_unit(F, layer, cu >> 5, (cu >> 1) & 15, cu & 1);
#endif
#ifndef NO_P2SL
            if (cu < 16) lru_unit<true>(F, layer, 0, cu & 7, cu >> 3);
#endif
#ifndef NO_P2SA
            if (cu >= 16 && cu < 48) { const int task = (cu - 16) * 8 + F.wave; attn_sample_task(F, layer, task >> 1, task & 1); }
#endif
        }
        PHASE_END();
        {
            LAUNDER();
            pg8::Gemm g{WSP(bf16, WS_OH), WSP(bf16, WS_WO + layer * SZ_WO), MPAD, D, KO};
            pg8::StaticOrder S; S.init(MPAD, D, 256, cu);
            EpiMerge E{WSP(bf16, WS_GA), WSP(bf16, WS_GL), WSP(bf16, WS_MG)};
#ifndef NO_P4
            pg8::gemm_phase<EpiMerge, pg8::StaticOrder, true, true, 8>(F.lds + RING_OFF, g, S, E);
#endif
        }
        PHASE_END();
        {
            LAUNDER();
            pg8::Gemm g{WSP(bf16, WS_MG), WSP(bf16, WS_WOUT + layer * SZ_SQ), MPAD, D, D};
            pg8::StaticOrder S; S.init(MPAD, D, 256, cu);
            EpiResid E{OUTP, WSP(bf16, WS_XB0), SSb};
#ifndef NO_P57
            pg8::gemm_phase<EpiResid, pg8::StaticOrder, true, true, 0>(F.lds + RING_OFF, g, S, E);
#endif
        }
        PHASE_END();
        {
            LAUNDER();
            pg8::Gemm g{WSP(bf16, WS_XB0), WSP(bf16, WS_WGU + layer * SZ_WGU), MPAD, NGU, D};
            pg8::StaticOrder S; S.init(MPAD, NGU, 256, cu);
            EpiGLU E{SSb, WSP(bf16, WS_H)};
#ifndef NO_P6
            pg8::gemm_phase<EpiGLU, pg8::StaticOrder, true, true, 0>(F.lds + RING_OFF, g, S, E);
#endif
            const int c2 = cu - 150;
            if (c2 >= 0) {
                pg8::Gemm g2{WSP(bf16, WS_PB + layer * SZ_PB), WSP(bf16, WS_WPL + layer * SZ_WPL), MPAD, D, PLE};
                pg8::StaticOrder S2; S2.init(MPAD, D, 106, c2);
                EpiF32 E2{WSP(float, WS_PP)};
#ifndef NO_PP
                pg8::gemm_phase<EpiF32, pg8::StaticOrder, true, true, 0>(F.lds + RING_OFF, g2, S2, E2);
#endif
            }
        }
        PHASE_END();
        {
            LAUNDER();
            pg8::Gemm g{WSP(bf16, WS_H), WSP(bf16, WS_WDN + layer * SZ_WDN), MPAD, D, DFF};
            pg8::StaticOrder S; S.init(MPAD, D, 256, cu);
            EpiResid E{OUTP, WSP(bf16, WS_XB1), SSa};
#ifndef NO_P57
            pg8::gemm_phase<EpiResid, pg8::StaticOrder, true, true, 0>(F.lds + RING_OFF, g, S, E);
#endif
        }
        PHASE_END();
        {
            LAUNDER();
            pg8::Gemm g{WSP(bf16, WS_XB1), WSP(bf16, WS_WPG + layer * SZ_SQ), MPAD, D, D};
            pg8::StaticOrder S; S.init(MPAD, D, 256, cu);
            EpiPle E{SSa, WSP(float, WS_PP), OUTP, WSP(bf16, WS_XB0), SSb};
#ifndef NO_P8
            pg8::gemm_phase<EpiPle, pg8::StaticOrder, true, true, 0>(F.lds + RING_OFF, g, S, E);
#endif
        }
}

__global__ void __launch_bounds__(512, 2) hybrid_fwd(Args args) {
    extern __shared__ __attribute__((aligned(16))) unsigned char lds_raw[];
    Frame F;
    F.lds = (LAS unsigned char*)lds_raw;
    F.tid = threadIdx.x; F.lane = F.tid & 63; F.wave = __builtin_amdgcn_readfirstlane(F.tid >> 6);
    F.cu = blockIdx.x; F.in = args.in; F.out = (GAS float*)args.out; F.ws = (GAS unsigned char*)args.ws;
    volatile LAS unsigned* MISC = (volatile LAS unsigned*)(F.lds + MISC_OFF);
    for (int u = F.tid; u < (LDS_BYTES - LDSCTL_OFF) / 4; u += 512) ((LAS unsigned*)(F.lds + LDSCTL_OFF))[u] = 0u;
    __syncthreads();
    XcdBarrier bar = xcd_barrier_post((unsigned*)(GAS unsigned*)(F.ws + WS_CTL) + CW_BAR, MISC + 8);
    int phase_no = 0;

#ifndef NO_P0
    p0_prologue(F);
#endif
    PHASE_END();

    layer_fwd(F, bar, 0, phase_no); PHASE_END();
    layer_fwd(F, bar, 1, phase_no); PHASE_END();
    layer_fwd(F, bar, 2, phase_no); PHASE_END();
    layer_fwd(F, bar, 3, phase_no);
}

extern "C" void kernel_launch(void* const* d_in, const int* in_sizes, int n_in, void* d_out, int out_size, void* d_ws, size_t ws_size, hipStream_t stream) {
    static int ready = 0;
    if (ready == 0) {
        if (n_in != 31 || out_size != (int)O_END || ws_size < WS_END) { fprintf(stderr, "kernel_launch: unexpected shapes: n_in %d out %d ws %zu (need %zu)\n", n_in, out_size, ws_size, (size_t)WS_END); ready = -1; return; }
        if (hipFuncSetAttribute((const void*)hybrid_fwd, hipFuncAttributeMaxDynamicSharedMemorySize, LDS_BYTES) != hipSuccess) { fprintf(stderr, "kernel_launch: hipFuncSetAttribute failed\n"); ready = -1; return; }
        int dev = 0, cus = 0, per_cu = 0;
        (void)hipGetDevice(&dev); (void)hipDeviceGetAttribute(&cus, hipDeviceAttributeMultiprocessorCount, dev);
        (void)hipOccupancyMaxActiveBlocksPerMultiprocessor(&per_cu, (const void*)hybrid_fwd, 512, LDS_BYTES);
        if (cus != 256 || per_cu < 1) fprintf(stderr, "kernel_launch: note: %d CUs, occupancy query %d blocks/CU (built for 256 CUs, 1 block each)\n", cus, per_cu);
        (void)hipGetLastError();
        ready = 1;
    }
    if (ready < 0) return;
    (void)hipMemsetAsync((char*)d_ws + WS_CTL, 0, CTL_ZERO_BYTES, stream);
    Args a{};
    for (int i = 0; i < 31; ++i) a.in[i] = (const float*)d_in[i];
    a.out = (float*)d_out; a.ws = (unsigned char*)d_ws;
    hipLaunchKernelGGL(hybrid_fwd, dim3(256), dim3(512), LDS_BYTES, stream, a);
}
```
